# Optimizing an MI355X kernel written in HIP

```python
import jax, jax.numpy as jnp
from jax import lax
import numpy as np

D_MODEL = 1024
BATCH = 8
SEQ = 2048
DEPTH = 1
DEC_BATCH = 16
DEC_SEQ = 16
PAST_LEN = 2048

CHUNK = 64
RET_HEADS = 4
RET_DK = 128
RET_DV = 128
RET_THETA = 10000.0
RET_W = RET_HEADS * RET_DV
SWA_HEADS = 8
SWA_KV_HEADS = 2
SWA_HD = 64
SWA_REP = SWA_HEADS // SWA_KV_HEADS
SWA_WINDOW = 128
SWA_NB = SWA_WINDOW // CHUNK
SWA_ROT_DIM = SWA_HD // 4
SWA_THETA = 500000.0
SWA_W = SWA_HEADS * SWA_HD
MIX_W = RET_W + SWA_W
D_FF = 4 * D_MODEL
PROJ_SPLITS = (RET_HEADS * RET_DK, RET_HEADS * RET_DK, RET_W, RET_W, SWA_W, SWA_KV_HEADS * SWA_HD, SWA_KV_HEADS * SWA_HD)
PROJ_OFFSETS = tuple(int(o) for o in np.cumsum(PROJ_SPLITS)[:-1])
PROJ_W = int(sum(PROJ_SPLITS))
ALPHA = (2.0 * DEPTH) ** 0.25
BETA = (8.0 * DEPTH) ** -0.25
LN_EPS = 1e-5
GN_EPS = 1e-5
NEG_INF = -1e30

kernel_name = "hybrid_retention_swa_streaming_step"


def rope(x, pos, rot_dim, theta):
    half = rot_dim // 2
    inv = theta ** (-jnp.arange(half, dtype=jnp.float32) / half)
    ang = pos.astype(jnp.float32)[:, None] * inv[None, :]
    cos = jnp.cos(ang)[:, None, :]
    sin = jnp.sin(ang)[:, None, :]
    xr = x[..., :rot_dim].astype(jnp.float32)
    x1, x2 = xr[..., :half], xr[..., half:]
    rot = jnp.concatenate([x1 * cos - x2 * sin, x2 * cos + x1 * sin], axis=-1).astype(x.dtype)
    return jnp.concatenate([rot, x[..., rot_dim:]], axis=-1)


def layer_norm(x, w, b):
    xf = x.astype(jnp.float32)
    mu = xf.mean(-1, keepdims=True)
    var = jnp.square(xf - mu).mean(-1, keepdims=True)
    return ((xf - mu) * lax.rsqrt(var + LN_EPS) * w + b).astype(x.dtype)


def in_proj(x, pos, w_in):
    b, t, _ = x.shape
    p = jnp.einsum('btd,de->bte', x, w_in)
    rq, rk, rv, rg, sq, sk, sv = jnp.split(p, PROJ_OFFSETS, axis=-1)
    rq = rope(rq.reshape(b, t, RET_HEADS, RET_DK), pos, RET_DK, RET_THETA)
    rk = rope(rk.reshape(b, t, RET_HEADS, RET_DK) * (RET_DK ** -0.5), pos, RET_DK, RET_THETA)
    rv = rv.reshape(b, t, RET_HEADS, RET_DV)
    sq = rope(sq.reshape(b, t, SWA_HEADS, SWA_HD), pos, SWA_ROT_DIM, SWA_THETA)
    sk = rope(sk.reshape(b, t, SWA_KV_HEADS, SWA_HD), pos, SWA_ROT_DIM, SWA_THETA)
    sv = sv.reshape(b, t, SWA_KV_HEADS, SWA_HD)
    return rq, rk, rv, rg, sq, sk, sv


def ret_log_gamma():
    return jnp.log1p(-(2.0 ** (-5.0 - jnp.arange(RET_HEADS, dtype=jnp.float32))))


def retention_chunk(s, q, k, v):
    t = q.shape[1]
    lg = ret_log_gamma()
    idx = jnp.arange(t, dtype=jnp.float32)
    diff = idx[:, None] - idx[None, :]
    dmask = jnp.where(diff >= 0, jnp.exp(lg[:, None, None] * jnp.maximum(diff, 0.0)), 0.0)
    scores = jnp.einsum('bnhd,bmhd->bhnm', q, k) * dmask
    o = jnp.einsum('bhnm,bmhe->bnhe', scores, v)
    q_decay = jnp.exp(lg[None, :] * (idx[:, None] + 1.0))
    o = o + jnp.einsum('bnhd,bhde->bnhe', q, s) * q_decay[None, :, :, None]
    k_decay = jnp.exp(lg[None, :] * (t - 1.0 - idx[:, None]))
    s_new = jnp.exp(lg * t)[None, :, None, None] * s + jnp.einsum('bmhd,bmhe->bhde', k * k_decay[None, :, :, None], v)
    return o, s_new


def retention_prompt(q, k, v):
    b, L = q.shape[:2]
    nc = L // CHUNK

    def to_chunks(a):
        return a.astype(jnp.float32).reshape(b, nc, CHUNK, RET_HEADS, -1).transpose(1, 0, 2, 3, 4)

    def step(s, qkv):
        o, s_new = retention_chunk(s, *qkv)
        return s_new, o

    s0 = jnp.zeros((b, RET_HEADS, RET_DK, RET_DV), jnp.float32)
    s_fin, o = lax.scan(step, s0, (to_chunks(q), to_chunks(k), to_chunks(v)))
    o = o.transpose(1, 0, 2, 3, 4).reshape(b, L, RET_HEADS, RET_DV)
    return o, s_fin


def retention_out(o, g, gn_w):
    b, t = o.shape[:2]
    mu = o.mean(-1, keepdims=True)
    var = jnp.square(o - mu).mean(-1, keepdims=True)
    on = ((o - mu) * lax.rsqrt(var + GN_EPS)).reshape(b, t, RET_W) * gn_w
    return (jax.nn.silu(g.astype(jnp.float32)) * on).astype(g.dtype)


def sink_softmax(s, sinks):
    snk = jnp.broadcast_to(sinks.astype(jnp.float32).reshape(SWA_KV_HEADS, SWA_REP, 1, 1), s.shape[:-1] + (1,))
    p = jax.nn.softmax(jnp.concatenate([s, snk], axis=-1), axis=-1)
    return p[..., :-1]


def swa_prompt(q, k, v, sinks):
    b, L = q.shape[:2]
    nc = L // CHUNK
    qc = q.reshape(b, nc, CHUNK, SWA_KV_HEADS, SWA_REP, SWA_HD)

    def band(a):
        ap = jnp.pad(a, ((0, 0), (SWA_WINDOW, 0), (0, 0), (0, 0))).reshape(b, nc + SWA_NB, CHUNK, SWA_KV_HEADS, SWA_HD)
        return jnp.concatenate([ap[:, j:j + nc] for j in range(SWA_NB + 1)], axis=2)

    kb, vb = band(k), band(v)
    kb_len = (SWA_NB + 1) * CHUNK
    kpos = jnp.arange(nc)[:, None] * CHUNK - SWA_WINDOW + jnp.arange(kb_len)[None, :]
    valid = kpos >= 0
    s = jnp.einsum('bcqgrd,bckgd->bcgrqk', qc, kb).astype(jnp.float32) * (SWA_HD ** -0.5)
    s = jnp.where(valid[None, :, None, None, None, :], s, NEG_INF)
    p = sink_softmax(s, sinks)
    o = jnp.einsum('bcgrqk,bckgd->bcqgrd', p.astype(v.dtype), vb)
    return o.reshape(b, L, SWA_W)


def swa_sample(q, k_new, v_new, cache_k, cache_v, sinks):
    b, t = q.shape[:2]
    kk = jnp.concatenate([cache_k.astype(k_new.dtype), k_new], axis=1)
    vv = jnp.concatenate([cache_v.astype(v_new.dtype), v_new], axis=1)
    qg = q.reshape(b, t, SWA_KV_HEADS, SWA_REP, SWA_HD)
    s = jnp.einsum('btgrd,bkgd->bgrtk', qg, kk).astype(jnp.float32) * (SWA_HD ** -0.5)
    p = sink_softmax(s, sinks)
    o = jnp.einsum('bgrtk,bkgd->btgrd', p.astype(vv.dtype), vv)
    return o.reshape(b, t, SWA_W)


def post_block(x, mix, w_out, ln1_w, ln1_b, w_up, w_down, ln2_w, ln2_b):
    x = layer_norm(ALPHA * x + jnp.einsum('btm,md->btd', mix, w_out), ln1_w, ln1_b)
    h = jnp.square(jax.nn.relu(jnp.einsum('btd,df->btf', x, w_up)))
    return layer_norm(ALPHA * x + jnp.einsum('btf,fd->btd', h, w_down), ln2_w, ln2_b)


def setup_inputs(seed: int = 0) -> dict:
    key = jax.random.key(seed)
    ks = jax.random.split(key, 16)
    win = min(SWA_WINDOW, PAST_LEN)
    f32 = jnp.float32
    return {
        "x_prompt": jax.random.normal(ks[0], (BATCH, SEQ, D_MODEL), f32),
        "x_sample": jax.random.normal(ks[1], (DEC_BATCH, DEC_SEQ, D_MODEL), f32),
        "cache_swa_k": jax.random.normal(ks[2], (DEPTH, DEC_BATCH, win, SWA_KV_HEADS, SWA_HD), f32),
        "cache_swa_v": jax.random.normal(ks[3], (DEPTH, DEC_BATCH, win, SWA_KV_HEADS, SWA_HD), f32),
        "state_ret": 0.5 * jax.random.normal(ks[4], (DEPTH, DEC_BATCH, RET_HEADS, RET_DK, RET_DV), f32),
        "w_in": jax.random.normal(ks[5], (DEPTH, D_MODEL, PROJ_W), f32) * D_MODEL ** -0.5,
        "ret_gn_w": 1.0 + 0.02 * jax.random.normal(ks[6], (DEPTH, RET_W), f32),
        "swa_sinks": 0.5 * jax.random.normal(ks[7], (DEPTH, SWA_HEADS), f32),
        "w_out": jax.random.normal(ks[8], (DEPTH, MIX_W, D_MODEL), f32) * (MIX_W ** -0.5) * BETA,
        "ln1_w": 1.0 + 0.02 * jax.random.normal(ks[9], (DEPTH, D_MODEL), f32),
        "ln1_b": 0.02 * jax.random.normal(ks[10], (DEPTH, D_MODEL), f32),
        "w_up": jax.random.normal(ks[11], (DEPTH, D_MODEL, D_FF), f32) * D_MODEL ** -0.5,
        "w_down": jax.random.normal(ks[12], (DEPTH, D_FF, D_MODEL), f32) * (D_FF ** -0.5) * BETA,
        "ln2_w": 1.0 + 0.02 * jax.random.normal(ks[13], (DEPTH, D_MODEL), f32),
        "ln2_b": 0.02 * jax.random.normal(ks[14], (DEPTH, D_MODEL), f32),
    }


def reference(x_prompt, x_sample, cache_swa_k, cache_swa_v, state_ret, w_in, ret_gn_w, swa_sinks,
              w_out, ln1_w, ln1_b, w_up, w_down, ln2_w, ln2_b):
    pos_p = jnp.arange(x_prompt.shape[1])
    pos_s = PAST_LEN + jnp.arange(x_sample.shape[1])
    xp, xs = x_prompt, x_sample
    k_p, v_p, r_p, k_s, v_s, r_s = [], [], [], [], [], []
    for l in range(DEPTH):
        rq, rk, rv, rg, sq, sk, sv = in_proj(xp, pos_p, w_in[l])
        o_ret, s_fin = retention_prompt(rq, rk, rv)
        mix = jnp.concatenate([retention_out(o_ret, rg, ret_gn_w[l]), swa_prompt(sq, sk, sv, swa_sinks[l])], axis=-1)
        xp_new = post_block(xp, mix, w_out[l], ln1_w[l], ln1_b[l], w_up[l], w_down[l], ln2_w[l], ln2_b[l])
        k_p.append(sk[:, -SWA_WINDOW:])
        v_p.append(sv[:, -SWA_WINDOW:])
        r_p.append(s_fin.astype(xp.dtype))
        xp = xp_new
        rq, rk, rv, rg, sq, sk, sv = in_proj(xs, pos_s, w_in[l])
        o_ret, s_new = retention_chunk(state_ret[l].astype(jnp.float32), rq.astype(jnp.float32),
                                       rk.astype(jnp.float32), rv.astype(jnp.float32))
        mix = jnp.concatenate([retention_out(o_ret, rg, ret_gn_w[l]),
                               swa_sample(sq, sk, sv, cache_swa_k[l], cache_swa_v[l], swa_sinks[l])], axis=-1)
        xs_new = post_block(xs, mix, w_out[l], ln1_w[l], ln1_b[l], w_up[l], w_down[l], ln2_w[l], ln2_b[l])
        k_s.append(sk)
        v_s.append(sv)
        r_s.append(s_new.astype(state_ret.dtype))
        xs = xs_new
    return (xp, xs, jnp.stack(k_p), jnp.stack(v_p), jnp.stack(r_p), jnp.stack(k_s), jnp.stack(v_s), jnp.stack(r_s))
```

```cpp
#include <hip/hip_runtime.h>
#include <cstdint>
#include <cstdio>

constexpr int D = 1024, BATCH = 8, SEQ = 2048, DECB = 16, DECS = 16, PAST = 2048;
constexpr int MP = BATCH * SEQ;
constexpr int MS = DECB * DECS;
constexpr int M = MP + MS;
constexpr int PW = 2816, FF = 4096;
constexpr int NPOS = PAST + DECS;
constexpr float ALPHA = 1.189207115002721f;
constexpr float LN_EPS = 1e-5f, GN_EPS = 1e-5f;
constexpr float QSCALE = 0.125f * 1.4426950408889634f;
constexpr float LOG2E = 1.4426950408889634f;
constexpr float RK_SCALE = 0.08838834764831845f;
constexpr size_t O_Y = 0;
constexpr size_t O_KP = (size_t)M * D;
constexpr size_t O_VP = O_KP + 8 * 128 * 128;
constexpr size_t O_RP = O_VP + 8 * 128 * 128;
constexpr size_t O_KS = O_RP + 8 * 4 * 128 * 128;
constexpr size_t O_VS = O_KS + 16 * 16 * 128;
constexpr size_t O_RS = O_VS + 16 * 16 * 128;
constexpr size_t O_END = O_RS + 16 * 4 * 128 * 128;
constexpr size_t MiB = 1u << 20;
constexpr size_t WS_CTL = 0;
constexpr size_t WS_TABR = 1 * MiB;
constexpr size_t WS_TABS = 2 * MiB + 512 * 1024;
constexpr size_t WS_PROJ = 81 * MiB;
constexpr size_t WS_MIX = 171 * MiB;
constexpr size_t WS_X1B = 204 * MiB;
constexpr size_t WS_H = 48 * MiB;
constexpr size_t WS_END = 256 * MiB;

typedef unsigned short bf16;
__device__ __forceinline__ unsigned f2bf(float f) { unsigned u = __builtin_bit_cast(unsigned, f); return (u + 0x7fffu + ((u >> 16) & 1u)) >> 16; }
__device__ __forceinline__ float bf2f(unsigned short h) { return __builtin_bit_cast(float, (unsigned)h << 16); }
__device__ __forceinline__ float rbf(float f) { return bf2f((unsigned short)f2bf(f)); }
__device__ __forceinline__ float lg2_gamma(int h) { return log2f(1.0f - exp2f(-5.0f - (float)h)); }

__device__ __forceinline__ float block_sum256(float v, float* red) {
#pragma unroll
    for (int o = 1; o < 64; o <<= 1) v += __shfl_xor(v, o);
    __syncthreads();
    if ((threadIdx.x & 63) == 0) red[threadIdx.x >> 6] = v;
    __syncthreads();
    return (red[0] + red[1]) + (red[2] + red[3]);
}

__global__ void k_tables(float2* tabr, float2* tabs) {
    const int i = blockIdx.x * blockDim.x + threadIdx.x;
    if (i < NPOS * 64) { const int pos = i / 64, f = i % 64; const float inv = powf(10000.0f, -(float)f / 64.0f); const float a = (float)pos * inv; tabr[i] = make_float2(cosf(a), sinf(a)); }
    if (i < NPOS * 8) { const int pos = i / 8, f = i % 8; const float inv = powf(500000.0f, -(float)f / 8.0f); const float a = (float)pos * inv; tabs[i] = make_float2(cosf(a), sinf(a)); }
}

template <int ROWS, int NCPT, bool A_BF16, class Epi>
__global__ void __launch_bounds__(256) gemm_rows(const void* A0, const void* A1, int split_row, int lda, const float* B, int K, int N, Epi epi) {
    __shared__ float As[ROWS][64];
    __shared__ float rowbuf[NCPT * 256];
    __shared__ float red[8];
    const int row0 = blockIdx.x * ROWS, tid = threadIdx.x;
    float acc[ROWS][NCPT];
#pragma unroll
    for (int r = 0; r < ROWS; ++r)
#pragma unroll
        for (int j = 0; j < NCPT; ++j) acc[r][j] = 0.f;
    for (int k0 = 0; k0 < K; k0 += 64) {
        for (int i = tid; i < ROWS * 64; i += 256) {
            const int r = i / 64, kk = i % 64; const int row = row0 + r;
            float v;
            if (A_BF16) v = bf2f(((const bf16*)A0)[(size_t)row * lda + k0 + kk]);
            else v = rbf(row < split_row ? ((const float*)A0)[(size_t)row * lda + k0 + kk] : ((const float*)A1)[(size_t)(row - split_row) * lda + k0 + kk]);
            As[r][kk] = v;
        }
        __syncthreads();
        for (int kk = 0; kk < 64; ++kk) {
            float b[NCPT];
#pragma unroll
            for (int j = 0; j < NCPT; ++j) b[j] = rbf(B[(size_t)(k0 + kk) * N + tid + 256 * j]);
#pragma unroll
            for (int r = 0; r < ROWS; ++r) { const float a = As[r][kk];
#pragma unroll
                for (int j = 0; j < NCPT; ++j) acc[r][j] += a * b[j]; }
        }
        __syncthreads();
    }
#pragma unroll
    for (int r = 0; r < ROWS; ++r) {
#pragma unroll
        for (int j = 0; j < NCPT; ++j) rowbuf[tid + 256 * j] = acc[r][j];
        __syncthreads();
        epi(row0 + r, rowbuf, tid, red);
        __syncthreads();
    }
}

struct EpiInProj {
    bf16* PROJ; float* out; const float2* tabr; const float2* tabs;
    __device__ void operator()(int row, const float* rb, int tid, float*) const {
        int b, t, pos; const bool sample = row >= MP;
        if (!sample) { b = row / SEQ; t = row % SEQ; pos = t; } else { const int rr = row - MP; b = rr / DECS; t = rr % DECS; pos = PAST + t; }
        const int j = pos & 63;
        for (int c = tid; c < PW; c += 256) {
            const float v = rb[c]; float o;
            if (c < 1024) {
                const int cc = c & 511, h = cc >> 7, d = cc & 127, i = d & 63;
                const float2 cs = tabr[pos * 64 + i];
                float x1 = rb[c - d + i], x2 = rb[c - d + i + 64];
                const float sc = (c >= 512) ? RK_SCALE : 1.f; x1 *= sc; x2 *= sc;
                const float r = (d < 64) ? (x1 * cs.x - x2 * cs.y) : (x2 * cs.x + x1 * cs.y);
                const float dec = exp2f(lg2_gamma(h) * (float)(c < 512 ? j : -j));
                o = r * dec;
            } else if (c < 1536) o = v;
            else if (c < 2048) o = v / (1.f + expf(-v));
            else if (c < 2688) {
                const int d = (c - 2048) & 63;
                if (d < 16) { const int i = d & 7; const float2 cs = tabs[pos * 8 + i]; const float x1 = rb[c - d + i], x2 = rb[c - d + i + 8]; o = (d < 8) ? (x1 * cs.x - x2 * cs.y) : (x2 * cs.x + x1 * cs.y); }
                else o = v;
                if (c < 2560) o *= QSCALE;
                else { const int g = (c - 2560) >> 6;
                    if (!sample && t >= SEQ - 128) out[O_KP + ((size_t)(b * 128 + (t - (SEQ - 128))) * 2 + g) * 64 + d] = o;
                    if (sample) out[O_KS + ((size_t)(b * DECS + t) * 2 + g) * 64 + d] = o; }
            } else { o = v; const int g = (c - 2688) >> 6, d = (c - 2688) & 63;
                if (!sample && t >= SEQ - 128) out[O_VP + ((size_t)(b * 128 + (t - (SEQ - 128))) * 2 + g) * 64 + d] = o;
                if (sample) out[O_VS + ((size_t)(b * DECS + t) * 2 + g) * 64 + d] = o; }
            PROJ[(size_t)row * PW + c] = (bf16)f2bf(o);
        }
    }
};
struct EpiLn1 {
    const float* xp; const float* xs; const float* w; const float* bb; float* Y; bf16* X1B;
    __device__ void operator()(int row, const float* rb, int tid, float* red) const {
        const float* xr = row < MP ? xp + (size_t)row * D : xs + (size_t)(row - MP) * D;
        float v[4]; float s = 0.f;
#pragma unroll
        for (int j = 0; j < 4; ++j) { v[j] = ALPHA * xr[tid + 256 * j] + rb[tid + 256 * j]; s += v[j]; }
        const float mean = block_sum256(s, red) * (1.f / D); float q = 0.f;
#pragma unroll
        for (int j = 0; j < 4; ++j) { v[j] -= mean; q += v[j] * v[j]; }
        const float rstd = 1.f / sqrtf(block_sum256(q, red) * (1.f / D) + LN_EPS);
#pragma unroll
        for (int j = 0; j < 4; ++j) { const int c = tid + 256 * j; const float o = v[j] * rstd * w[c] + bb[c]; Y[(size_t)row * D + c] = o; X1B[(size_t)row * D + c] = (bf16)f2bf(o); }
    }
};
struct EpiRelu2 {
    bf16* H;
    __device__ void operator()(int row, const float* rb, int tid, float*) const {
#pragma unroll
        for (int j = 0; j < 16; ++j) { const int c = tid + 256 * j; const float v = fmaxf(rb[c], 0.f); H[(size_t)row * FF + c] = (bf16)f2bf(v * v); }
    }
};
struct EpiLn2 {
    const float* w; const float* bb; float* Y;
    __device__ void operator()(int row, const float* rb, int tid, float* red) const {
        float v[4]; float s = 0.f;
#pragma unroll
        for (int j = 0; j < 4; ++j) { v[j] = ALPHA * Y[(size_t)row * D + tid + 256 * j] + rb[tid + 256 * j]; s += v[j]; }
        const float mean = block_sum256(s, red) * (1.f / D); float q = 0.f;
#pragma unroll
        for (int j = 0; j < 4; ++j) { v[j] -= mean; q += v[j] * v[j]; }
        const float rstd = 1.f / sqrtf(block_sum256(q, red) * (1.f / D) + LN_EPS);
#pragma unroll
        for (int j = 0; j < 4; ++j) { const int c = tid + 256 * j; Y[(size_t)row * D + c] = v[j] * rstd * w[c] + bb[c]; }
    }
};

__global__ void __launch_bounds__(64) swa_prompt_naive(const bf16* PROJ, const float* sinks, bf16* MIX) {
    __shared__ float Ks[192][65]; __shared__ float Vs[192][65];
    const int bc = blockIdx.x, b = bc / 32, c = bc % 32, h = blockIdx.y, g = h >> 2, tid = threadIdx.x;
    const int c_lo = c >= 2 ? c - 2 : 0, nk = (c - c_lo + 1) * 64;
    for (int i = tid; i < nk * 64; i += 64) { const int kr = i / 64, d = i % 64; const size_t row = (size_t)b * SEQ + c_lo * 64 + kr;
        Ks[kr][d] = bf2f(PROJ[row * PW + 2560 + g * 64 + d]); Vs[kr][d] = bf2f(PROJ[row * PW + 2688 + g * 64 + d]); }
    __syncthreads();
    const size_t qrow = (size_t)b * SEQ + c * 64 + tid;
    float q[64];
#pragma unroll
    for (int d = 0; d < 64; ++d) q[d] = bf2f(PROJ[qrow * PW + 2048 + h * 64 + d]);
    const float snk = sinks[h] * LOG2E;
    float mx = snk;
    for (int k = 0; k < nk; ++k) { float s = 0.f;
#pragma unroll
        for (int d = 0; d < 64; ++d) s += q[d] * Ks[k][d];
        mx = fmaxf(mx, s); }
    float l = exp2f(snk - mx); float o[64];
#pragma unroll
    for (int d = 0; d < 64; ++d) o[d] = 0.f;
    for (int k = 0; k < nk; ++k) { float s = 0.f;
#pragma unroll
        for (int d = 0; d < 64; ++d) s += q[d] * Ks[k][d];
        const float p = exp2f(s - mx); l += p; const float pb = rbf(p);
#pragma unroll
        for (int d = 0; d < 64; ++d) o[d] += pb * Vs[k][d]; }
    const float il = 1.f / l;
#pragma unroll
    for (int d = 0; d < 64; ++d) MIX[qrow * D + 512 + h * 64 + d] = (bf16)f2bf(o[d] * il);
}
__global__ void __launch_bounds__(64) swa_sample_naive(const bf16* PROJ, const float* ck, const float* cv, const float* sinks, bf16* MIX) {
    __shared__ float Ks[144][65]; __shared__ float Vs[144][65];
    const int b = blockIdx.x, g = blockIdx.y, tid = threadIdx.x, r = tid >> 4, t = tid & 15, h = g * 4 + r;
    for (int i = tid; i < 144 * 64; i += 64) { const int kr = i / 64, d = i % 64;
        if (kr < 128) { Ks[kr][d] = rbf(ck[((size_t)(b * 128 + kr) * 2 + g) * 64 + d]); Vs[kr][d] = rbf(cv[((size_t)(b * 128 + kr) * 2 + g) * 64 + d]); }
        else { const size_t row = (size_t)MP + b * DECS + (kr - 128); Ks[kr][d] = bf2f(PROJ[row * PW + 2560 + g * 64 + d]); Vs[kr][d] = bf2f(PROJ[row * PW + 2688 + g * 64 + d]); } }
    __syncthreads();
    const size_t qrow = (size_t)MP + b * DECS + t;
    float q[64];
#pragma unroll
    for (int d = 0; d < 64; ++d) q[d] = bf2f(PROJ[qrow * PW + 2048 + h * 64 + d]);
    const float snk = sinks[h] * LOG2E;
    float mx = snk;
    for (int k = 0; k < 144; ++k) { float s = 0.f;
#pragma unroll
        for (int d = 0; d < 64; ++d) s += q[d] * Ks[k][d];
        mx = fmaxf(mx, s); }
    float l = exp2f(snk - mx); float o[64];
#pragma unroll
    for (int d = 0; d < 64; ++d) o[d] = 0.f;
    for (int k = 0; k < 144; ++k) { float s = 0.f;
#pragma unroll
        for (int d = 0; d < 64; ++d) s += q[d] * Ks[k][d];
        const float p = exp2f(s - mx); l += p; const float pb = rbf(p);
#pragma unroll
        for (int d = 0; d < 64; ++d) o[d] += pb * Vs[k][d]; }
    const float il = 1.f / l;
#pragma unroll
    for (int d = 0; d < 64; ++d) MIX[qrow * D + 512 + h * 64 + d] = (bf16)f2bf(o[d] * il);
}

template <bool SAMPLE>
__global__ void __launch_bounds__(128) ret_naive(const bf16* PROJ, const float* state_in, const float* gnw, bf16* MIX, float* out) {
    __shared__ float qs[128], ks[128], red[4];
    const int bh = blockIdx.x, h = bh & 3, b = bh >> 2, dv = threadIdx.x;
    const float lg = lg2_gamma(h), g1 = exp2f(lg), g64 = exp2f(64.f * lg);
    float T[128];
#pragma unroll
    for (int j = 0; j < 128; ++j) T[j] = SAMPLE ? g1 * state_in[((size_t)bh * 128 + j) * 128 + dv] : 0.f;
    const int ntok = SAMPLE ? DECS : SEQ;
    const size_t row0 = SAMPLE ? (size_t)MP + b * DECS : (size_t)b * SEQ;
    const float gw = gnw[h * 128 + dv];
    for (int t = 0; t < ntok; ++t) {
        const size_t row = row0 + t;
        __syncthreads();
        qs[dv] = bf2f(PROJ[row * PW + h * 128 + dv]); ks[dv] = bf2f(PROJ[row * PW + 512 + h * 128 + dv]);
        __syncthreads();
        const float v = bf2f(PROJ[row * PW + 1024 + h * 128 + dv]);
        float o = 0.f;
#pragma unroll
        for (int j = 0; j < 128; ++j) { T[j] += ks[j] * v; o += qs[j] * T[j]; }
        float s = o;
#pragma unroll
        for (int x = 1; x < 64; x <<= 1) s += __shfl_xor(s, x);
        if ((dv & 63) == 0) red[dv >> 6] = s;
        __syncthreads();
        const float mean = (red[0] + red[1]) * (1.f / 128.f); const float dd = o - mean; float q = dd * dd;
#pragma unroll
        for (int x = 1; x < 64; x <<= 1) q += __shfl_xor(q, x);
        if ((dv & 63) == 0) red[2 + (dv >> 6)] = q;
        __syncthreads();
        const float rstd = 1.f / sqrtf((red[2] + red[3]) * (1.f / 128.f) + GN_EPS);
        const float sg = bf2f(PROJ[row * PW + 1536 + h * 128 + dv]);
        MIX[row * D + h * 128 + dv] = (bf16)f2bf(sg * (dd * rstd * gw));
        if ((t & 63) == 63 && t + 1 < ntok) {
#pragma unroll
            for (int j = 0; j < 128; ++j) T[j] *= g64;
        }
    }
    const float gf = exp2f(lg * (float)(((ntok - 1) & 63)));
    float* so = out + (SAMPLE ? O_RS : O_RP) + (size_t)bh * 128 * 128;
#pragma unroll
    for (int j = 0; j < 128; ++j) so[(size_t)j * 128 + dv] = gf * T[j];
}

extern "C" void kernel_launch(void* const* d_in, const int* in_sizes, int n_in, void* d_out, int out_size, void* d_ws, size_t ws_size, hipStream_t stream) {
    if (n_in != 15 || (size_t)out_size != O_END || ws_size < WS_END) { fprintf(stderr, "kernel_launch: unexpected shapes n_in %d out %d ws %zu\n", n_in, out_size, ws_size); return; }
    const float* x_p = (const float*)d_in[0]; const float* x_s = (const float*)d_in[1];
    const float* ck = (const float*)d_in[2]; const float* cv = (const float*)d_in[3]; const float* st = (const float*)d_in[4];
    const float* w_in = (const float*)d_in[5]; const float* gnw = (const float*)d_in[6]; const float* sinks = (const float*)d_in[7];
    const float* w_out = (const float*)d_in[8]; const float* ln1w = (const float*)d_in[9]; const float* ln1b = (const float*)d_in[10];
    const float* w_up = (const float*)d_in[11]; const float* w_down = (const float*)d_in[12]; const float* ln2w = (const float*)d_in[13]; const float* ln2b = (const float*)d_in[14];
    float* out = (float*)d_out; unsigned char* ws = (unsigned char*)d_ws;
    float2* tabr = (float2*)(ws + WS_TABR); float2* tabs = (float2*)(ws + WS_TABS);
    bf16* PROJ = (bf16*)(ws + WS_PROJ); bf16* MIX = (bf16*)(ws + WS_MIX); bf16* X1B = (bf16*)(ws + WS_X1B); bf16* H = (bf16*)(ws + WS_H);
    float* Y = out + O_Y;
    k_tables<<<(NPOS * 64 + 255) / 256, 256, 0, stream>>>(tabr, tabs);
    gemm_rows<8, 11, false, EpiInProj><<<M / 8, 256, 0, stream>>>(x_p, x_s, MP, D, w_in, D, PW, EpiInProj{PROJ, out, tabr, tabs});
    swa_prompt_naive<<<dim3(BATCH * 32, 8), 64, 0, stream>>>(PROJ, sinks, MIX);
    swa_sample_naive<<<dim3(DECB, 2), 64, 0, stream>>>(PROJ, ck, cv, sinks, MIX);
    ret_naive<false><<<BATCH * 4, 128, 0, stream>>>(PROJ, nullptr, gnw, MIX, out);
    ret_naive<true><<<DECB * 4, 128, 0, stream>>>(PROJ, st, gnw, MIX, out);
    gemm_rows<8, 4, true, EpiLn1><<<M / 8, 256, 0, stream>>>(MIX, nullptr, M, D, w_out, D, D, EpiLn1{x_p, x_s, ln1w, ln1b, Y, X1B});
    gemm_rows<8, 16, true, EpiRelu2><<<M / 8, 256, 0, stream>>>(X1B, nullptr, M, D, w_up, D, FF, EpiRelu2{H});
    gemm_rows<8, 4, true, EpiLn2><<<M / 8, 256, 0, stream>>>(H, nullptr, M, FF, w_down, FF, D, EpiLn2{ln2w, ln2b, Y});
}
```
